# Optimizing an MI355X kernel written in HIP

```python
import math
import jax, jax.numpy as jnp
from jax import lax
import numpy as np

D_MODEL = 2048
BATCH = 16
SEQ = 2048
DEPTH = 4

N_MIXERS = 2
N_HGRN = (DEPTH + 1) // 2
N_DIFF = DEPTH // 2
D_FF = 5632
MACARON_W = 0.5
HGRN_EXPAND = 128
HGRN_HEADS = D_MODEL // HGRN_EXPAND
HGRN_KDIM = HGRN_EXPAND
HGRN_VDIM = D_MODEL // HGRN_HEADS
HGRN_KEY = HGRN_HEADS * HGRN_KDIM
HGRN_VAL = HGRN_HEADS * HGRN_VDIM
HGRN_CHUNK = 32
MIN_LOWER = 1e-30
DIFF_HEAD_DIM = 128
DIFF_HEADS = D_MODEL // (2 * DIFF_HEAD_DIM)
DIFF_QK = 2 * DIFF_HEADS * DIFF_HEAD_DIM
DIFF_V = DIFF_HEADS * 2 * DIFF_HEAD_DIM
Q_BLOCK = 128
REL_BUCKETS = 32
REL_MAX_DIST = 128
NORM_EPS = 1e-6
SUBLN_EPS = 1e-5

kernel_name = 'hybrid_hgrn2_diffattn_macaron'


def rms_norm(x, gain, eps=NORM_EPS):
    xf = x.astype(jnp.float32)
    y = xf * lax.rsqrt(jnp.mean(xf * xf, axis=-1, keepdims=True) + eps) * gain.astype(jnp.float32)
    return y.astype(x.dtype)


def swiglu_ffn(h, w_in, w_out):
    gate, up = jnp.split(h @ w_in, 2, axis=-1)
    return (jax.nn.silu(gate) * up) @ w_out


def t5_bucket(dist):
    n = jnp.maximum(dist, 0)
    max_exact = REL_BUCKETS // 2
    is_small = n < max_exact
    nf = jnp.maximum(n, max_exact).astype(jnp.float32)
    large = max_exact + (jnp.log(nf / max_exact) / math.log(REL_MAX_DIST / max_exact)
                         * (REL_BUCKETS - max_exact)).astype(jnp.int32)
    large = jnp.minimum(large, REL_BUCKETS - 1)
    return jnp.where(is_small, n, large)


def hgrn2_mixer(h, w_in, lower, norm_gain, w_out):
    B, S, _ = h.shape
    C = HGRN_CHUNK
    N = S // C
    proj = h @ w_in
    q, fz, v, og = jnp.split(proj, [HGRN_KEY, 2 * HGRN_KEY, 2 * HGRN_KEY + HGRN_VAL], axis=-1)
    q = jax.nn.silu(q.astype(jnp.float32))
    fz = fz.astype(jnp.float32)
    lb = lower.astype(jnp.float32)
    log_f = jnp.logaddexp(jnp.log(jnp.maximum(lb, MIN_LOWER)), jnp.log1p(-lb) + jax.nn.log_sigmoid(fz))
    k = (1.0 - lb) * jax.nn.sigmoid(-fz)
    v = v.astype(jnp.float32)

    def to_chunks(t, dh):
        return t.reshape(B, N, C, HGRN_HEADS, dh).transpose(1, 0, 3, 2, 4)

    qc, kc, gc = to_chunks(q, HGRN_KDIM), to_chunks(k, HGRN_KDIM), to_chunks(log_f, HGRN_KDIM)
    vc = to_chunks(v, HGRN_VDIM)
    mask = jnp.tril(jnp.ones((C, C), dtype=bool))[:, :, None]

    def step(state, inp):
        qi, ki, vi, gi = inp
        b = jnp.cumsum(gi, axis=2)
        b_last = b[:, :, -1:, :]
        diff = b[:, :, :, None, :] - b[:, :, None, :, :]
        dec = jnp.exp(jnp.where(mask, diff, -jnp.inf))
        a = jnp.einsum('bhtd,bhsd,bhtsd->bhts', qi, ki, dec)
        o = (jnp.einsum('bhts,bhsv->bhtv', a, vi)
             + jnp.einsum('bhtd,bhdv->bhtv', qi * jnp.exp(b), state))
        new_state = (jnp.exp(b_last[:, :, 0, :])[..., None] * state
                     + jnp.einsum('bhsd,bhsv->bhdv', ki * jnp.exp(b_last - b), vi))
        return new_state, o

    s0 = jnp.zeros((B, HGRN_HEADS, HGRN_KDIM, HGRN_VDIM), jnp.float32)
    _, oc = lax.scan(step, s0, (qc, kc, vc, gc))
    o = oc.transpose(1, 0, 3, 2, 4).reshape(B, S, HGRN_HEADS, HGRN_VDIM)
    o = rms_norm(o, norm_gain.reshape(HGRN_HEADS, HGRN_VDIM))
    o = o.reshape(B, S, HGRN_VAL) * jax.nn.silu(og.astype(jnp.float32))
    return o.astype(h.dtype) @ w_out


def diff_attention(h, w_in, lam_p, subln, w_out, rel_bias, layer_idx):
    B, S, _ = h.shape
    H, d = DIFF_HEADS, DIFF_HEAD_DIM
    NB = S // Q_BLOCK
    proj = h @ w_in
    q, k, v = jnp.split(proj, [DIFF_QK, 2 * DIFF_QK], axis=-1)
    q = q.reshape(B, S, H, 2, d)
    k = k.reshape(B, S, H, 2, d)
    v = v.reshape(B, S, H, 2 * d)
    k1, k2 = k[:, :, :, 0], k[:, :, :, 1]
    q1b = q[:, :, :, 0].reshape(B, NB, Q_BLOCK, H, d).transpose(1, 0, 2, 3, 4)
    q2b = q[:, :, :, 1].reshape(B, NB, Q_BLOCK, H, d).transpose(1, 0, 2, 3, 4)
    lam_init = 0.8 - 0.6 * math.exp(-0.3 * layer_idx)
    lp = lam_p.astype(jnp.float32)
    lam = jnp.exp(jnp.sum(lp[0] * lp[1])) - jnp.exp(jnp.sum(lp[2] * lp[3])) + lam_init
    scale = d ** -0.5
    key_pos = jnp.arange(S)

    def block(args):
        i, a1, a2 = args
        qpos = i * Q_BLOCK + jnp.arange(Q_BLOCK)
        dist = qpos[:, None] - key_pos[None, :]
        causal = dist >= 0
        bias = rel_bias[t5_bucket(dist)].transpose(2, 0, 1).astype(jnp.float32)
        s1 = jnp.einsum('bqhd,bkhd->bhqk', a1, k1).astype(jnp.float32) * scale + bias
        s2 = jnp.einsum('bqhd,bkhd->bhqk', a2, k2).astype(jnp.float32) * scale + bias
        p1 = jax.nn.softmax(jnp.where(causal, s1, -jnp.inf), axis=-1)
        p2 = jax.nn.softmax(jnp.where(causal, s2, -jnp.inf), axis=-1)
        w = (p1 - lam * p2).astype(v.dtype)
        return jnp.einsum('bhqk,bkhv->bqhv', w, v)

    ob = lax.map(block, (jnp.arange(NB), q1b, q2b))
    o = ob.transpose(1, 0, 2, 3, 4).reshape(B, S, H, 2 * d)
    o = rms_norm(o, subln, SUBLN_EPS) * (1.0 - lam_init)
    return o.reshape(B, S, DIFF_V).astype(h.dtype) @ w_out


def setup_inputs(seed: int = 0) -> dict:
    key = jax.random.key(seed)
    ks = jax.random.split(key, 14)

    def nrm(k, shape, scale):
        return jax.random.normal(k, shape, jnp.float32) * scale

    return {
        'x': nrm(ks[0], (BATCH, SEQ, D_MODEL), 1.0),
        'norm_gains': 1.0 + nrm(ks[1], (DEPTH, 3, D_MODEL), 0.02),
        'final_norm': 1.0 + nrm(ks[2], (D_MODEL,), 0.02),
        'ffn_w_in': nrm(ks[3], (DEPTH, 2, D_MODEL, 2 * D_FF), D_MODEL ** -0.5),
        'ffn_w_out': nrm(ks[4], (DEPTH, 2, D_FF, D_MODEL), D_FF ** -0.5),
        'hgrn_w_in': nrm(ks[5], (N_HGRN, D_MODEL, 2 * HGRN_KEY + 2 * HGRN_VAL), D_MODEL ** -0.5),
        'hgrn_lower_bounds': nrm(ks[6], (N_HGRN, HGRN_KEY), 0.5),
        'hgrn_norm': 1.0 + nrm(ks[7], (N_HGRN, HGRN_VAL), 0.02),
        'hgrn_w_out': nrm(ks[8], (N_HGRN, HGRN_VAL, D_MODEL), HGRN_VAL ** -0.5),
        'diff_w_in': nrm(ks[9], (N_DIFF, D_MODEL, 2 * DIFF_QK + DIFF_V), D_MODEL ** -0.5),
        'diff_lambda': nrm(ks[10], (N_DIFF, 4, DIFF_HEAD_DIM), 0.1),
        'diff_subln': 1.0 + nrm(ks[11], (N_DIFF, 2 * DIFF_HEAD_DIM), 0.02),
        'diff_w_out': nrm(ks[12], (N_DIFF, DIFF_V, D_MODEL), DIFF_V ** -0.5),
        'rel_bias': nrm(ks[13], (REL_BUCKETS, DIFF_HEADS), 0.5),
    }


def reference(x, norm_gains, final_norm, ffn_w_in, ffn_w_out, hgrn_w_in, hgrn_lower_bounds,
              hgrn_norm, hgrn_w_out, diff_w_in, diff_lambda, diff_subln, diff_w_out, rel_bias):
    sm = jax.nn.softmax(hgrn_lower_bounds.astype(jnp.float32), axis=0)
    lower = jnp.cumsum(sm, axis=0) - sm[0]
    h = x
    for i in range(DEPTH):
        j = i // N_MIXERS
        h = h + MACARON_W * swiglu_ffn(rms_norm(h, norm_gains[i, 0]), ffn_w_in[i, 0], ffn_w_out[i, 0])
        hn = rms_norm(h, norm_gains[i, 1])
        if i % N_MIXERS == 0:
            mix = hgrn2_mixer(hn, hgrn_w_in[j], lower[j], hgrn_norm[j], hgrn_w_out[j])
        else:
            mix = diff_attention(hn, diff_w_in[j], diff_lambda[j], diff_subln[j], diff_w_out[j], rel_bias, i)
        h = h + mix.astype(h.dtype)
        h = h + MACARON_W * swiglu_ffn(rms_norm(h, norm_gains[i, 2]), ffn_w_in[i, 1], ffn_w_out[i, 1])
    return rms_norm(h, final_norm)
```

```cpp
#include <hip/hip_runtime.h>
#include <cstdio>
#include <cstdint>
namespace pg8 {
#define PG8_LAS __attribute__((address_space(3)))
typedef unsigned short bf16_t;
typedef short bf16x8 __attribute__((ext_vector_type(8)));
typedef float f32x4 __attribute__((ext_vector_type(4)));
typedef unsigned u32x4 __attribute__((ext_vector_type(4)));
constexpr int BM = 256, BK = 64, HALF = 128, HTB = HALF * BK * 2  , STAGE_BYTES = 8 * HTB, NXCD = 8, WGM = 8;

__host__ __device__ __forceinline__ int lds_byte(int r, int c) { const int st = (r >> 4) * 2 + (c >> 5), rr = r & 15, cc = c & 31, ob = rr * 64 + cc * 2; return st * 1024 + (ob ^ (((ob >> 9) & 1) << 5)); }
__host__ __device__ __forceinline__ void stage_rc(int b, int& R, int& C) { const int st = b / 1024, sb = b % 1024, swz = sb ^ (((sb >> 9) & 1) << 5); R = (st >> 1) * 16 + swz / 64; C = (st & 1) * 32 + (swz % 64) / 2; }
__host__ __device__ __forceinline__ int perm32(int rho) { const int n = rho >> 4, i = rho & 15; return 8 * (i >> 2) + 4 * n + (i & 3); }

struct Unit { int pm, pn; };
struct Gemm { const bf16_t* A; const bf16_t* Bt; int M, N, K; };

struct StaticOrder {
    int nM, nN, nwg, G, c;
    __host__ __device__ void init(int M, int N, int G_, int c_) { nM = M / BM; nN = N / BM; nwg = nM * nN; G = G_; c = c_; }
    __host__ __device__ bool next(int i, Unit& u) const {
        const long L = (long)i * G + c; if (L >= nwg) return false;
        int wgid = (int)L; { const int q = nwg / NXCD, r = nwg % NXCD, xcd = wgid % NXCD, off = wgid / NXCD; wgid = (xcd < r ? xcd * (q + 1) : r * (q + 1) + (xcd - r) * q) + off; }
        const int nig = WGM * nN, gid = wgid / nig, fm = gid * WGM, gsz = (nM - fm) < WGM ? (nM - fm) : WGM;
        u.pm = fm + ((wgid % nig) % gsz); u.pn = (wgid % nig) / gsz; return true;
    }
    __device__ __forceinline__ void a_ready(const Unit&) const {}
    __device__ __forceinline__ void done(const Unit&) const {}
};
__device__ __forceinline__ unsigned cvt_pk_bf16(float lo, float hi) { unsigned r; asm volatile("v_cvt_pk_bf16_f32 %0, %1, %2" : "=v"(r) : "v"(lo), "v"(hi)); return r; }
typedef float f32x2 __attribute__((ext_vector_type(2)));
template <int ACT  > struct EpiBf16 {
    static constexpr bool PERM = true, AFTER_DRAIN = false; static_assert(ACT == 0, "EpiBf16: ACT is 0 (none)");
    bf16_t* O; int ldc; const float* bias; int split_cols; size_t split_stride; float scale0;
    __device__ __forceinline__ void operator()(const f32x4 (&acc)[2][2][4][2], const Unit& u, int wr, int wc, int fr, int fq) const {
        const int row0 = u.pm * BM + wr * 64 + fr; int colt = u.pn * BM; bf16_t* base = O;
        float sc = 1.f; if (split_cols) { const int t = colt / split_cols; base += (size_t)t * split_stride; colt -= t * split_cols; if (t == 0) sc = scale0; }
        const int col0 = colt + wc * 32 + 8 * fq, bcol0 = u.pn * BM + wc * 32 + 8 * fq;
        f32x4 bv[2][2];
#pragma unroll
        for (int bj = 0; bj < 2; ++bj)
#pragma unroll
            for (int n = 0; n < 2; ++n) bv[bj][n] = bias ? *(const f32x4*)(bias + bcol0 + bj * HALF + 4 * n) : (f32x4){0.f, 0.f, 0.f, 0.f};
#pragma unroll
        for (int ai = 0; ai < 2; ++ai)
#pragma unroll
            for (int m = 0; m < 4; ++m) { bf16_t* rowp = base + (size_t)(row0 + ai * HALF + m * 16) * ldc + col0;
#pragma unroll
                for (int bj = 0; bj < 2; ++bj) { f32x4 v0 = acc[ai][bj][m][0] + bv[bj][0], v1 = acc[ai][bj][m][1] + bv[bj][1];
                    v0 = v0 * sc; v1 = v1 * sc; u32x4 w; w.x = cvt_pk_bf16(v0[0], v0[1]); w.y = cvt_pk_bf16(v0[2], v0[3]); w.z = cvt_pk_bf16(v1[0], v1[1]); w.w = cvt_pk_bf16(v1[2], v1[3]);
                    *(u32x4*)(rowp + bj * HALF) = w; } }
    }
};
__device__ __forceinline__ float fast_sigmoid(float x) { return __builtin_amdgcn_rcpf(1.0f + __builtin_amdgcn_exp2f(-1.4426950408889634f * x)); }
__device__ __forceinline__ float fast_silu(float x) { return x * fast_sigmoid(x); }
struct EpiSwiglu {
    static constexpr bool PERM = true, AFTER_DRAIN = false;
    bf16_t* O; int ldc;
    __device__ __forceinline__ void operator()(const f32x4 (&acc)[2][2][4][2], const Unit& u, int wr, int wc, int fr, int fq) const {
        const int row0 = u.pm * BM + wr * 64 + fr, col0 = u.pn * HALF + wc * 32 + 8 * fq;
#pragma unroll
        for (int ai = 0; ai < 2; ++ai)
#pragma unroll
            for (int m = 0; m < 4; ++m) {
                bf16_t* rowp = O + (size_t)(row0 + ai * HALF + m * 16) * ldc + col0;
                const f32x4 g0 = acc[ai][0][m][0], g1 = acc[ai][0][m][1], u0 = acc[ai][1][m][0], u1 = acc[ai][1][m][1];
                u32x4 w;
                w.x = cvt_pk_bf16(fast_silu(g0[0]) * u0[0], fast_silu(g0[1]) * u0[1]); w.y = cvt_pk_bf16(fast_silu(g0[2]) * u0[2], fast_silu(g0[3]) * u0[3]);
                w.z = cvt_pk_bf16(fast_silu(g1[0]) * u1[0], fast_silu(g1[1]) * u1[1]); w.w = cvt_pk_bf16(fast_silu(g1[2]) * u1[2], fast_silu(g1[3]) * u1[3]);
                *(u32x4*)rowp = w;
            }
    }
};
struct EpiRes {
    static constexpr bool PERM = false, AFTER_DRAIN = false;
    const float* base; float* out; int ldc; float scale;
    __device__ __forceinline__ void operator()(const f32x4 (&acc)[2][2][4][2], const Unit& u, int wr, int wc, int fr, int fq) const {
        const int row0 = u.pm * BM + wr * 64 + fr, col0 = u.pn * BM + wc * 32 + 4 * fq;
#pragma unroll
        for (int ai = 0; ai < 2; ++ai)
#pragma unroll
            for (int m = 0; m < 4; ++m) { const size_t off = (size_t)(row0 + ai * HALF + m * 16) * ldc + col0;
                f32x4 bs[2][2];
#pragma unroll
                for (int bj = 0; bj < 2; ++bj)
#pragma unroll
                    for (int n = 0; n < 2; ++n) bs[bj][n] = *(const f32x4*)(base + off + bj * HALF + n * 16);
#pragma unroll
                for (int bj = 0; bj < 2; ++bj)
#pragma unroll
                    for (int n = 0; n < 2; ++n) *(f32x4*)(out + off + bj * HALF + n * 16) = bs[bj][n] + acc[ai][bj][m][n] * scale;
                asm volatile("" ::: "memory"); }
    }
};
struct EpiHgrn {
    static constexpr bool PERM = true, AFTER_DRAIN = false;
    unsigned char* big; size_t tstride; const float *lowA, *low1, *lowm;
    __device__ __forceinline__ void operator()(const f32x4 (&acc)[2][2][4][2], const Unit& u, int wr, int wc, int fr, int fq) const {
        const int type = u.pn >> 3, col0 = (u.pn & 7) * BM + wc * 32 + 8 * fq, row0 = u.pm * BM + wr * 64 + fr;
        if (type == 1) { bf16_t* Kb = (bf16_t*)(big + tstride); float* G = (float*)(big + 4 * tstride);
#pragma unroll
            for (int bj = 0; bj < 2; ++bj) { const int c = col0 + bj * HALF;
                float A8[8], B8[8], M8[8];
#pragma unroll
                for (int e = 0; e < 8; ++e) { A8[e] = lowA[c + e]; B8[e] = low1[c + e]; M8[e] = lowm[c + e]; }
#pragma unroll
                for (int ai = 0; ai < 2; ++ai)
#pragma unroll
                    for (int m = 0; m < 4; ++m) { const size_t off = (size_t)(row0 + ai * HALF + m * 16) * 2048 + c;
                        float lf[8], kk[8];
#pragma unroll
                        for (int e = 0; e < 8; ++e) { const float z = acc[ai][bj][m][e >> 2][e & 3];
                            const float ls = fminf(z, 0.f) - 0.6931471805599453f * __builtin_amdgcn_logf(1.0f + __builtin_amdgcn_exp2f(-1.4426950408889634f * fabsf(z)));
                            const float bv = B8[e] + ls, mx = fmaxf(A8[e], bv), dd = fabsf(A8[e] - bv);
                            lf[e] = mx + 0.6931471805599453f * __builtin_amdgcn_logf(1.0f + __builtin_amdgcn_exp2f(-1.4426950408889634f * dd));
                            kk[e] = M8[e] * fast_sigmoid(-z); }
                        *(f32x4*)(G + off) = (f32x4){lf[0], lf[1], lf[2], lf[3]}; *(f32x4*)(G + off + 4) = (f32x4){lf[4], lf[5], lf[6], lf[7]};
                        u32x4 w; w.x = cvt_pk_bf16(kk[0], kk[1]); w.y = cvt_pk_bf16(kk[2], kk[3]); w.z = cvt_pk_bf16(kk[4], kk[5]); w.w = cvt_pk_bf16(kk[6], kk[7]);
                        *(u32x4*)(Kb + off) = w; } }
        } else {
            bf16_t* dst = (bf16_t*)(big + (size_t)type * tstride); const bool act = type != 2;
#pragma unroll
            for (int ai = 0; ai < 2; ++ai)
#pragma unroll
                for (int m = 0; m < 4; ++m)
#pragma unroll
                    for (int bj = 0; bj < 2; ++bj) { f32x4 v0 = acc[ai][bj][m][0], v1 = acc[ai][bj][m][1];
                        if (act) { v0 = (f32x4){fast_silu(v0[0]), fast_silu(v0[1]), fast_silu(v0[2]), fast_silu(v0[3])}; v1 = (f32x4){fast_silu(v1[0]), fast_silu(v1[1]), fast_silu(v1[2]), fast_silu(v1[3])}; }
                        u32x4 w; w.x = cvt_pk_bf16(v0[0], v0[1]); w.y = cvt_pk_bf16(v0[2], v0[3]); w.z = cvt_pk_bf16(v1[0], v1[1]); w.w = cvt_pk_bf16(v1[2], v1[3]);
                        *(u32x4*)(dst + (size_t)(row0 + ai * HALF + m * 16) * 2048 + col0 + bj * HALF) = w; }
        }
    }
};

template <class Epi, class Sched, bool ALIGN_EPI = false, bool SP2 = false>
__device__ __forceinline__ void gemm_phase(PG8_LAS unsigned char* lds, const Gemm g, const Sched& S, const Epi& E) {
    int tid_ = threadIdx.x; asm volatile("" : "+v"(tid_));
    const int tid = tid_, wid = __builtin_amdgcn_readfirstlane(tid >> 6), lane = tid & 63, wr = wid >> 2, wc = wid & 3, fr = lane & 15, fq = lane >> 4;
    const int K = g.K, nt = K / BK;
    unsigned voffA[2], voffB[2];
#pragma unroll
    for (int i = 0; i < 2; ++i) { int R, C; stage_rc(tid * 16 + i * 8192, R, C); const int Rb = Epi::PERM ? ((R & ~31) + perm32(R & 31)) : R;
        voffA[i] = (unsigned)(R * K + C) * 2u; voffB[i] = (unsigned)(Rb * K + C) * 2u; }
    const size_t kstep = (size_t)(BK * 2);
    const size_t hstep = (size_t)HALF * K * 2;
    const size_t tstep = 2 * hstep;
    const unsigned ldsw = (unsigned)wid * 1024u;
    const int aoff = lds_byte(wr * 64 + fr, fq * 8), boff = lds_byte(wc * 32 + fr, fq * 8);
#define PG8_SA(b, h) (((b) * 2 + (h)) * HTB)
#define PG8_SB(b, h) ((4 + (b) * 2 + (h)) * HTB)
#define PG8_STAGE(bufoff, gbase, voff) do { _Pragma("unroll") for (int _i = 0; _i < 2; ++_i) \
        __builtin_amdgcn_global_load_lds((const unsigned*)((const char*)(gbase) + (voff)[_i]), (PG8_LAS unsigned*)(lds + (bufoff) + ldsw + _i * 8192), 16, 0, 0); } while (0)
#define PG8_LDA(dst, b, h) do { _Pragma("unroll") for (int m = 0; m < 4; ++m) _Pragma("unroll") for (int k = 0; k < 2; ++k) dst[m][k] = *(const PG8_LAS bf16x8*)(lds + PG8_SA(b, h) + aoff + m * 2048 + k * 1024); } while (0)
#define PG8_LDB(dst, b, h) do { _Pragma("unroll") for (int n = 0; n < 2; ++n) _Pragma("unroll") for (int k = 0; k < 2; ++k) dst[n][k] = *(const PG8_LAS bf16x8*)(lds + PG8_SB(b, h) + boff + n * 2048 + k * 1024); } while (0)
#define PG8_MMA(ai, bj, At, Bt) do { __builtin_amdgcn_s_setprio(1); _Pragma("unroll") for (int m = 0; m < 4; ++m) _Pragma("unroll") for (int n = 0; n < 2; ++n) _Pragma("unroll") for (int k = 0; k < 2; ++k) \
        acc[ai][bj][m][n] = __builtin_amdgcn_mfma_f32_16x16x32_bf16(Bt[n][k], At[m][k], acc[ai][bj][m][n], 0, 0, 0); __builtin_amdgcn_s_setprio(0); } while (0)
#define PG8_WAIT_V(n) asm volatile("s_waitcnt vmcnt(" #n ")" ::: "memory")
#define PG8_WAIT_L(n) asm volatile("s_waitcnt lgkmcnt(" #n ")" ::: "memory")
#define PG8_BAR __builtin_amdgcn_s_barrier()
#define PG8_SCHED __builtin_amdgcn_sched_barrier(0)
    Unit cur, nxt; int ui = 0;
    if (!S.next(0, cur)) return;
    f32x4 acc[2][2][4][2];
#pragma unroll
    for (int a = 0; a < 2; ++a)
#pragma unroll
        for (int b = 0; b < 2; ++b)
#pragma unroll
            for (int m = 0; m < 4; ++m)
#pragma unroll
                for (int n = 0; n < 2; ++n) acc[a][b][m][n] = (f32x4){0.f, 0.f, 0.f, 0.f};
    bf16x8 At[4][2], B0[2][2], B1[2][2];
    const char* cA = (const char*)g.A + (size_t)cur.pm * tstep; const char* cB = (const char*)g.Bt + (size_t)cur.pn * tstep;
    S.a_ready(cur);
    if constexpr (SP2) {
        PG8_STAGE(PG8_SB(0, 0), cB, voffB); PG8_STAGE(PG8_SB(0, 1), cB + hstep, voffB); PG8_STAGE(PG8_SA(0, 0), cA, voffA); PG8_STAGE(PG8_SA(0, 1), cA + hstep, voffA);
        if (wr == 1) PG8_BAR;
        PG8_WAIT_V(2); PG8_BAR;
        PG8_STAGE(PG8_SB(1, 0), cB + kstep, voffB); PG8_STAGE(PG8_SA(1, 0), cA + kstep, voffA); PG8_STAGE(PG8_SB(1, 1), cB + hstep + kstep, voffB);
        PG8_WAIT_V(6); PG8_BAR;
    } else {
        PG8_STAGE(PG8_SB(0, 0), cB, voffB); PG8_STAGE(PG8_SA(0, 0), cA, voffA); PG8_STAGE(PG8_SB(0, 1), cB + hstep, voffB); PG8_STAGE(PG8_SA(0, 1), cA + hstep, voffA);
        if (wr == 1) PG8_BAR;
        PG8_WAIT_V(4); PG8_BAR;
        PG8_STAGE(PG8_SB(1, 0), cB + kstep, voffB); PG8_STAGE(PG8_SA(1, 0), cA + kstep, voffA); PG8_STAGE(PG8_SB(1, 1), cB + hstep + kstep, voffB);
        PG8_WAIT_V(6); PG8_BAR;
    }
    for (;;) {
        const bool has_next = S.next(ui + 1, nxt);
        const char* nA = has_next ? (const char*)g.A + (size_t)nxt.pm * tstep : cA; const char* nB = has_next ? (const char*)g.Bt + (size_t)nxt.pn * tstep : cB;
        for (int t = 0; t < nt; t += 2) {
            const bool last = (t == nt - 2);
            const char* a1 = cA + (size_t)(t + 1) * kstep;
            const char* a2 = last ? nA : cA + (size_t)(t + 2) * kstep; const char* b2 = last ? nB : cB + (size_t)(t + 2) * kstep;
            const char* a3 = a2 + kstep; const char* b3 = b2 + kstep;
            if (last && has_next) S.a_ready(nxt);
            if constexpr (SP2) {
            PG8_LDB(B0, 0, 0); PG8_LDB(B1, 0, 1); PG8_SCHED; PG8_LDA(At, 0, 0); PG8_STAGE(PG8_SA(1, 1), a1 + hstep, voffA);
            PG8_WAIT_V(8); PG8_WAIT_L(0); PG8_BAR; PG8_MMA(0, 0, At, B0); PG8_MMA(0, 1, At, B1); PG8_BAR; PG8_SCHED;
            PG8_LDA(At, 0, 1); PG8_STAGE(PG8_SB(0, 0), b2, voffB); PG8_STAGE(PG8_SB(0, 1), b2 + hstep, voffB); PG8_STAGE(PG8_SA(0, 0), a2, voffA);
            PG8_WAIT_V(8); PG8_WAIT_L(0); PG8_BAR; PG8_MMA(1, 0, At, B0); PG8_MMA(1, 1, At, B1); PG8_BAR; PG8_SCHED;
            PG8_LDB(B0, 1, 0); PG8_LDB(B1, 1, 1); PG8_SCHED; PG8_LDA(At, 1, 0); PG8_STAGE(PG8_SA(0, 1), a2 + hstep, voffA);
            PG8_WAIT_V(8); PG8_WAIT_L(0); PG8_BAR; PG8_MMA(0, 0, At, B0); PG8_MMA(0, 1, At, B1); PG8_BAR; PG8_SCHED;
            PG8_LDA(At, 1, 1); PG8_STAGE(PG8_SB(1, 0), b3, voffB); PG8_STAGE(PG8_SB(1, 1), b3 + hstep, voffB); PG8_STAGE(PG8_SA(1, 0), a3, voffA);
            PG8_WAIT_V(8); PG8_WAIT_L(0); PG8_BAR; PG8_MMA(1, 0, At, B0); PG8_MMA(1, 1, At, B1); PG8_BAR; PG8_SCHED;
            } else {
            PG8_LDB(B0, 0, 0); PG8_SCHED; PG8_LDA(At, 0, 0); PG8_STAGE(PG8_SA(1, 1), a1 + hstep, voffA);
            PG8_WAIT_L(8); PG8_BAR; PG8_WAIT_L(0); PG8_MMA(0, 0, At, B0); PG8_BAR; PG8_SCHED;
            PG8_LDB(B1, 0, 1); PG8_STAGE(PG8_SB(0, 0), b2, voffB);
            PG8_BAR; PG8_WAIT_L(0); PG8_MMA(0, 1, At, B1); PG8_BAR;
            PG8_LDA(At, 0, 1); PG8_STAGE(PG8_SA(0, 0), a2, voffA);
            PG8_BAR; PG8_WAIT_L(0); PG8_MMA(1, 0, At, B0); PG8_BAR; PG8_SCHED;
            PG8_STAGE(PG8_SB(0, 1), b2 + hstep, voffB);
            PG8_WAIT_V(6); PG8_BAR; PG8_MMA(1, 1, At, B1); PG8_BAR;
            PG8_LDB(B0, 1, 0); PG8_SCHED; PG8_LDA(At, 1, 0); PG8_STAGE(PG8_SA(0, 1), a2 + hstep, voffA);
            PG8_WAIT_L(8); PG8_BAR; PG8_WAIT_L(0); PG8_MMA(0, 0, At, B0); PG8_BAR; PG8_SCHED;
            PG8_LDB(B1, 1, 1); PG8_STAGE(PG8_SB(1, 0), b3, voffB);
            PG8_BAR; PG8_WAIT_L(0); PG8_MMA(0, 1, At, B1); PG8_BAR;
            PG8_LDA(At, 1, 1); PG8_STAGE(PG8_SA(1, 0), a3, voffA);
            PG8_BAR; PG8_WAIT_L(0); PG8_MMA(1, 0, At, B0); PG8_BAR; PG8_SCHED;
            PG8_STAGE(PG8_SB(1, 1), b3 + hstep, voffB);
            PG8_WAIT_V(6); PG8_BAR; PG8_MMA(1, 1, At, B1); PG8_BAR;
            }
        }
        if constexpr (ALIGN_EPI) { if (wr == 0) PG8_BAR; }
        if constexpr (!Epi::AFTER_DRAIN) { E(acc, cur, wr, wc, fr, fq); S.done(cur); }
        if (!has_next) break;
#pragma unroll
        for (int a = 0; a < 2; ++a)
#pragma unroll
            for (int b = 0; b < 2; ++b)
#pragma unroll
                for (int m = 0; m < 4; ++m)
#pragma unroll
                    for (int n = 0; n < 2; ++n) acc[a][b][m][n] = (f32x4){0.f, 0.f, 0.f, 0.f};
        cur = nxt; cA = nA; cB = nB; ++ui;
        if constexpr (ALIGN_EPI) { if (wr == 1) PG8_BAR; }
    }
    PG8_WAIT_V(0);
    if constexpr (!ALIGN_EPI) { if (wr == 0) PG8_BAR; }
    PG8_BAR;
    if constexpr (Epi::AFTER_DRAIN) { E.fused(acc, cur, wr, wc, fr, fq, lds, wid, lane); S.done(cur); }
#undef PG8_SA
#undef PG8_SB
#undef PG8_STAGE
#undef PG8_LDA
#undef PG8_LDB
#undef PG8_MMA
#undef PG8_WAIT_V
#undef PG8_WAIT_L
#undef PG8_BAR
#undef PG8_SCHED
}
}
#ifndef PG8_SP2
#define PG8_SP2 true
#endif
#ifndef PG8_ALIGN
#define PG8_ALIGN true
#endif
#ifndef MK_ONE_LAUNCH
#define MK_ONE_LAUNCH 0
#endif

constexpr int NWAVES = 8;
constexpr int DM = 2048, BATCH = 16, SEQ = 2048, M = BATCH * SEQ, DEPTH = 4, DFF = 5632, NFF2 = 2 * DFF;
constexpr int HG_HEADS = 16, HG_PROJ = 8192, DA_HEADS = 8, DA_PROJ = 6144;
constexpr float NORM_EPS = 1e-6f, SUBLN_EPS = 1e-5f;
constexpr float LOG2E = 1.4426950408889634f;
constexpr float QSCALE = 0.08838834764831845f * LOG2E;
constexpr int NPHASE = 42;

constexpr size_t MiB = 1u << 20;
constexpr size_t WS_CTL = 0, CTL_ZERO_BYTES = 1 * MiB;
constexpr size_t WS_TAB = 1 * MiB;
constexpr size_t WS_WFI = 2 * MiB;
constexpr size_t WS_WFO = WS_WFI + 352 * MiB;
constexpr size_t WS_WHI = WS_WFO + 176 * MiB;
constexpr size_t WS_WHO = WS_WHI + 64 * MiB;
constexpr size_t WS_WDI = WS_WHO + 16 * MiB;
constexpr size_t WS_WDO = WS_WDI + 48 * MiB;
constexpr size_t WS_HN  = WS_WDO + 16 * MiB;
constexpr size_t WS_MO  = WS_HN + 128 * MiB;
constexpr size_t WS_BIG = WS_MO + 128 * MiB;
constexpr size_t WS_END = WS_BIG + 768 * MiB;
constexpr size_t BIG_T = (size_t)M * DM * 2;
constexpr int T_LOWA = 0, T_LOW1 = 4096, T_LOWM = 8192, T_LAM = 12288  , T_BIAS = 12352  ;
constexpr int CW_BAR = 4096;

constexpr int RING_OFF = 0, RING_BYTES = 131072;
constexpr int LDSCTL_OFF = RING_BYTES, MISC_OFF = LDSCTL_OFF + 320;
constexpr int LDS_BYTES = 147456;

#define GAS __attribute__((address_space(1)))
#define LAS __attribute__((address_space(3)))
typedef unsigned short bf16;
typedef unsigned v4u __attribute__((ext_vector_type(4)));
typedef unsigned v2u __attribute__((ext_vector_type(2)));
typedef float f32x4 __attribute__((ext_vector_type(4)));
typedef float f32x2 __attribute__((ext_vector_type(2)));
typedef GAS unsigned gu32;
#define LDS_WAIT() asm volatile("s_waitcnt lgkmcnt(0)" ::: "memory")
__device__ __forceinline__ unsigned pk2(float lo, float hi) { unsigned r; asm volatile("v_cvt_pk_bf16_f32 %0, %1, %2" : "=v"(r) : "v"(lo), "v"(hi)); return r; }
__device__ __forceinline__ float bf2f(unsigned short b) { return __uint_as_float(((unsigned)b) << 16); }
__device__ __forceinline__ float bflo(unsigned w) { return __uint_as_float(w << 16); }
__device__ __forceinline__ float bfhi(unsigned w) { return __uint_as_float(w & 0xffff0000u); }
__device__ __forceinline__ int opaque_tid() { int t = threadIdx.x; asm volatile("" : "+v"(t)); return t; }
__device__ __forceinline__ float wave_sum(float v) {
#pragma unroll
    for (int o = 1; o < 64; o <<= 1) v += __shfl_xor(v, o);
    return v;
}
__device__ __forceinline__ float wave_max(float v) {
#pragma unroll
    for (int o = 1; o < 64; o <<= 1) v = fmaxf(v, __shfl_xor(v, o));
    return v;
}

#define XB_TMO      128
#define XB_XCNT(j)  (256  + 64 * (j))
#define XB_XSUB(j)  (1280 + 64 * (j))
#define XB_XGEN(j)  (2304 + 64 * (j))
#define XB_TOP      3328
#define XB_TOPGEN   3392
#define XCD_BAR_WORDS 3456
#define XB_SPIN_CAP (1u << 18)

__device__ __forceinline__ unsigned xb_ld(unsigned* p)              { return __hip_atomic_load(p, __ATOMIC_RELAXED, __HIP_MEMORY_SCOPE_AGENT); }
__device__ __forceinline__ unsigned xb_add(unsigned* p, unsigned v) { return __hip_atomic_fetch_add(p, v, __ATOMIC_RELAXED, __HIP_MEMORY_SCOPE_AGENT); }
__device__ __forceinline__ unsigned xb_xcc_id() { return (unsigned)__builtin_amdgcn_s_getreg((3 << 11) | 20) & 0xFu; }
#define XB_SPIN(cond, bar) do { unsigned _sp = 0; while (cond) { __builtin_amdgcn_s_sleep(1); \
    if ((++_sp & 255u) == 0u) { if (xb_ld(&(bar)[XB_TMO])) break; if (_sp > XB_SPIN_CAP) { atomicAdd(&(bar)[XB_TMO], 1u); break; } } } } while (0)

struct XcdBarrier {
    unsigned* bar; unsigned x;
    volatile LAS unsigned* st;
};

__device__ __forceinline__ XcdBarrier xcd_barrier_post(unsigned* bar, volatile LAS unsigned* st) {
    XcdBarrier b; b.bar = bar; b.x = xb_xcc_id(); b.st = st;
    if (threadIdx.x == 0) (void)xb_add(&bar[XB_XCNT(b.x)], 1u);
    return b;
}
__device__ __forceinline__ void xcd_barrier_complete(unsigned* bar, unsigned x, unsigned& nloc, unsigned& nx) {
    const unsigned G = gridDim.x * gridDim.y * gridDim.z;
    unsigned sum, cnt, mine, sp = 0u;
    for (;;) {
        sum = 0u; cnt = 0u; mine = 0u;
#pragma unroll
        for (unsigned j = 0; j < 16; ++j) { const unsigned c = xb_ld(&bar[XB_XCNT(j)]); sum += c; cnt += (c > 0u) ? 1u : 0u; mine = (j == x) ? c : mine; }
        if (sum == G) break;
        __builtin_amdgcn_s_sleep(1);
        if ((++sp & 255u) == 0u) { if (xb_ld(&bar[XB_TMO])) break; if (sp > XB_SPIN_CAP) { atomicAdd(&bar[XB_TMO], 1u); break; } }
    }
    nloc = mine > 0u ? mine : 1u; nx = cnt > 0u ? cnt : 1u;
}

__device__ __forceinline__ void xcd_barrier(const XcdBarrier& b) {
    asm volatile("s_waitcnt vmcnt(0)" ::: "memory");
    __syncthreads();
    if (threadIdx.x == 0) {
        unsigned* bar = b.bar;
        __builtin_amdgcn_s_waitcnt(0);
        unsigned nloc = b.st[0], nx = b.st[1];
        if (nloc == 0u) { xcd_barrier_complete(bar, b.x, nloc, nx); b.st[0] = nloc; b.st[1] = nx; }
        const unsigned old = xb_add(&bar[XB_XSUB(b.x)], 1u);
        const unsigned gen = old / nloc;
        if (old + 1u == (gen + 1u) * nloc) {
            __builtin_amdgcn_fence(__ATOMIC_RELEASE, "agent");
            asm volatile("s_waitcnt vmcnt(0)" ::: "memory");
            const unsigned og = xb_add(&bar[XB_TOP], 1u);
            const unsigned tg = og / nx;
            if (og + 1u == (tg + 1u) * nx) xb_add(&bar[XB_TOPGEN], 1u);
            else XB_SPIN(xb_ld(&bar[XB_TOPGEN]) == tg, bar);
            __builtin_amdgcn_fence(__ATOMIC_ACQUIRE, "agent");
            xb_add(&bar[XB_XGEN(b.x)], 1u);
            asm volatile("s_waitcnt vmcnt(0)" ::: "memory");
        } else {
            XB_SPIN(xb_ld(&bar[XB_XGEN(b.x)]) == gen, bar);
            __builtin_amdgcn_fence(__ATOMIC_ACQUIRE, "agent");
            asm volatile("s_waitcnt vmcnt(0)" ::: "memory");
        }
    }
    __syncthreads();
}
struct Frame {
    LAS unsigned char* lds;
    volatile LAS unsigned* MISC;
    gu32* ctl;
    int tid, lane, wave, G;
    const float *x, *norm_gains, *final_norm, *ffn_w_in, *ffn_w_out, *hgrn_w_in, *hgrn_lb, *hgrn_norm, *hgrn_w_out, *diff_w_in, *diff_lambda, *diff_subln, *diff_w_out, *rel_bias;
    float* out;
    float* tab;
    bf16 *WFI, *WFO, *WHI, *WHO, *WDI, *WDO, *HN, *MO;
    unsigned char* big;
};

template <bool FFN_PERM>
__device__ __forceinline__ void transpose_item(const float* W, int K, int N, bf16* WT, LAS float* scr, int item, int lane) {
    const int nblk = N / 32, kb = item / nblk, nb = item % nblk, k0 = 64 * kb, n0 = 32 * nb;
    int d0 = n0;
    if (FFN_PERM) { d0 = n0 < DFF ? ((n0 >> 7) * 256 + (n0 & 127)) : ((((n0 - DFF) >> 7) * 256) + 128 + ((n0 - DFF) & 127)); }
#pragma unroll 8
    for (int i = 0; i < 32; ++i) { const int kk = 2 * i + (lane >> 5); scr[kk * 33 + (lane & 31)] = W[(size_t)(k0 + kk) * N + n0 + (lane & 31)]; }
    LDS_WAIT(); asm volatile("" ::: "memory");
    const int c = lane & 7;
#pragma unroll
    for (int j = 0; j < 4; ++j) { const int n = (lane >> 3) + 8 * j; const LAS float* s = scr + (8 * c) * 33 + n;
        v4u o; o.x = pk2(s[0 * 33], s[1 * 33]); o.y = pk2(s[2 * 33], s[3 * 33]); o.z = pk2(s[4 * 33], s[5 * 33]); o.w = pk2(s[6 * 33], s[7 * 33]);
        *(GAS v4u*)(WT + (size_t)(d0 + n) * K + k0 + 8 * c) = o; }
    LDS_WAIT(); asm volatile("" ::: "memory");
}
__device__ __forceinline__ void p0_prologue(Frame& F) {
    const int tid = opaque_tid(), lane = tid & 63;
    LAS float* scr = (LAS float*)(F.lds + RING_OFF + F.wave * 16384);
    const int gw = blockIdx.x * NWAVES + F.wave, NGW = F.G * NWAVES;
    constexpr int IT_FI = (DM / 64) * (NFF2 / 32), IT_FO = (DFF / 64) * (DM / 32), IT_HI = (DM / 64) * (HG_PROJ / 32), IT_SQ = (DM / 64) * (DM / 32), IT_DI = (DM / 64) * (DA_PROJ / 32);
    constexpr int NITEMS = 8 * IT_FI + 8 * IT_FO + 2 * IT_HI + 2 * IT_SQ + 2 * IT_DI + 2 * IT_SQ;
    for (int it = gw; it < NITEMS; it += NGW) {
        int r = it;
        if (r < 8 * IT_FI) { const int w = r / IT_FI; r -= w * IT_FI; transpose_item<true>(F.ffn_w_in + (size_t)w * DM * NFF2, DM, NFF2, F.WFI + (size_t)w * NFF2 * DM, scr, r, lane); continue; } r -= 8 * IT_FI;
        if (r < 8 * IT_FO) { const int w = r / IT_FO; r -= w * IT_FO; transpose_item<false>(F.ffn_w_out + (size_t)w * DFF * DM, DFF, DM, F.WFO + (size_t)w * DM * DFF, scr, r, lane); continue; } r -= 8 * IT_FO;
        if (r < 2 * IT_HI) { const int w = r / IT_HI; r -= w * IT_HI; transpose_item<false>(F.hgrn_w_in + (size_t)w * DM * HG_PROJ, DM, HG_PROJ, F.WHI + (size_t)w * HG_PROJ * DM, scr, r, lane); continue; } r -= 2 * IT_HI;
        if (r < 2 * IT_SQ) { const int w = r / IT_SQ; r -= w * IT_SQ; transpose_item<false>(F.hgrn_w_out + (size_t)w * DM * DM, DM, DM, F.WHO + (size_t)w * DM * DM, scr, r, lane); continue; } r -= 2 * IT_SQ;
        if (r < 2 * IT_DI) { const int w = r / IT_DI; r -= w * IT_DI; transpose_item<false>(F.diff_w_in + (size_t)w * DM * DA_PROJ, DM, DA_PROJ, F.WDI + (size_t)w * DA_PROJ * DM, scr, r, lane); continue; } r -= 2 * IT_DI;
        { const int w = r / IT_SQ; r -= w * IT_SQ; transpose_item<false>(F.diff_w_out + (size_t)w * DM * DM, DM, DM, F.WDO + (size_t)w * DM * DM, scr, r, lane); }
    }
    if (blockIdx.x == 0) {
        for (int c = tid; c < DM; c += NWAVES * 64) {
            const float l0 = F.hgrn_lb[c], l1 = F.hgrn_lb[DM + c], mx = fmaxf(l0, l1), e0 = expf(l0 - mx), e1 = expf(l1 - mx), s0 = e0 / (e0 + e1), s1 = e1 / (e0 + e1);
            const float lw[2] = {s0 - s0, (s0 + s1) - s0};
#pragma unroll
            for (int j = 0; j < 2; ++j) { F.tab[T_LOWA + j * DM + c] = logf(fmaxf(lw[j], 1e-30f)); F.tab[T_LOW1 + j * DM + c] = log1pf(-lw[j]); F.tab[T_LOWM + j * DM + c] = 1.0f - lw[j]; }
        }
        if (F.wave == 0) {
#pragma unroll
            for (int j = 0; j < 2; ++j) { const float* lp = F.diff_lambda + j * 4 * 128;
                const float s1 = wave_sum(lp[lane] * lp[128 + lane] + lp[64 + lane] * lp[192 + lane]);
                const float s2 = wave_sum(lp[256 + lane] * lp[384 + lane] + lp[320 + lane] * lp[448 + lane]);
                const float lam_init = 0.8f - 0.6f * expf(-0.3f * (float)(2 * j + 1));
                if (lane == 0) { F.tab[T_LAM + j] = expf(s1) - expf(s2) + lam_init; F.tab[T_LAM + 2 + j] = 1.0f - lam_init; } }
        }
        for (int idx = tid; idx < DA_HEADS * 128; idx += NWAVES * 64) { const int h = idx >> 7, n = idx & 127;
            int bucket = n;
            if (n >= 16) { const int lg = 16 + (int)(logf((float)n / 16.0f) / 2.0794415416798357f * 16.0f); bucket = lg < 31 ? lg : 31; }
            F.tab[T_BIAS + idx] = F.rel_bias[bucket * DA_HEADS + h]; }
    }
}

__device__ __forceinline__ void rmsnorm_phase(Frame& F, const float* src, const float* gain, bf16* dst) {
    const int tid = opaque_tid(), lane = tid & 63; (void)tid;
    const int gw = blockIdx.x * NWAVES + F.wave, NGW = F.G * NWAVES;
    f32x4 g[8];
#pragma unroll
    for (int j = 0; j < 8; ++j) g[j] = ((const f32x4*)gain)[64 * j + lane];
    for (int m = gw; m < M; m += NGW) {
        const f32x4* xr = (const f32x4*)(src + (size_t)m * DM) + lane;
        f32x4 v[8]; float s = 0.f;
#pragma unroll
        for (int j = 0; j < 8; ++j) { v[j] = xr[64 * j]; s += (v[j].x * v[j].x + v[j].y * v[j].y) + (v[j].z * v[j].z + v[j].w * v[j].w); }
        const float r = rsqrtf(wave_sum(s) * (1.0f / DM) + NORM_EPS);
        v2u* o8 = (v2u*)(dst + (size_t)m * DM) + lane;
#pragma unroll
        for (int j = 0; j < 8; ++j) { v2u w; w.x = pk2(v[j].x * r * g[j].x, v[j].y * r * g[j].y); w.y = pk2(v[j].z * r * g[j].z, v[j].w * r * g[j].w); o8[64 * j] = w; }
    }
}
__device__ __forceinline__ void final_norm_phase(Frame& F) {
    const int tid = opaque_tid(), lane = tid & 63; (void)tid;
    const int gw = blockIdx.x * NWAVES + F.wave, NGW = F.G * NWAVES;
    f32x4 g[8];
#pragma unroll
    for (int j = 0; j < 8; ++j) g[j] = ((const f32x4*)F.final_norm)[64 * j + lane];
    for (int m = gw; m < M; m += NGW) {
        f32x4* xr = (f32x4*)(F.out + (size_t)m * DM) + lane;
        f32x4 v[8]; float s = 0.f;
#pragma unroll
        for (int j = 0; j < 8; ++j) { v[j] = xr[64 * j]; s += (v[j].x * v[j].x + v[j].y * v[j].y) + (v[j].z * v[j].z + v[j].w * v[j].w); }
        const float r = rsqrtf(wave_sum(s) * (1.0f / DM) + NORM_EPS);
#pragma unroll
        for (int j = 0; j < 8; ++j) xr[64 * j] = v[j] * r * g[j];
    }
}

__device__ __forceinline__ void scan_naive_phase(Frame& F, int j) {
    const int tid = opaque_tid(), lane = tid & 63; (void)tid;
    LAS float* qs = (LAS float*)(F.lds + RING_OFF); LAS float* ks = qs + 1024; LAS float* fs = ks + 1024; LAS float* osh = fs + 1024;
    const bf16* Q = (const bf16*)(F.big); const bf16* Kb = (const bf16*)(F.big + BIG_T); const bf16* V = (const bf16*)(F.big + 2 * BIG_T); const bf16* OG = (const bf16*)(F.big + 3 * BIG_T);
    const float* G = (const float*)(F.big + 4 * BIG_T); const float* gain = F.hgrn_norm + j * DM;
    for (int bh = blockIdx.x; bh < BATCH * HG_HEADS; bh += F.G) {
        const int b = bh >> 4, h = bh & 15;
        float S[128];
#pragma unroll
        for (int d = 0; d < 128; ++d) S[d] = 0.f;
        for (int t0 = 0; t0 < SEQ; t0 += 8) {
            for (int e = tid; e < 1024; e += NWAVES * 64) { const int tt = e >> 7, d = e & 127; const size_t idx = (size_t)(b * SEQ + t0 + tt) * DM + h * 128 + d;
                qs[e] = bf2f(Q[idx]); ks[e] = bf2f(Kb[idx]); fs[e] = __expf(G[idx]); }
            __syncthreads();
            if (tid < 128) {
                for (int tt = 0; tt < 8; ++tt) {
                    const float v = bf2f(V[(size_t)(b * SEQ + t0 + tt) * DM + h * 128 + tid]);
                    float o = 0.f;
#pragma unroll
                    for (int d = 0; d < 128; ++d) { S[d] = fs[tt * 128 + d] * S[d] + ks[tt * 128 + d] * v; o += qs[tt * 128 + d] * S[d]; }
                    osh[tt * 128 + tid] = o;
                }
            }
            __syncthreads();
            { const int tt = F.wave; const size_t idx = (size_t)(b * SEQ + t0 + tt) * DM + h * 128;
              const float a0 = osh[tt * 128 + lane], a1 = osh[tt * 128 + 64 + lane];
              const float r = rsqrtf(wave_sum(a0 * a0 + a1 * a1) * (1.0f / 128.0f) + NORM_EPS);
              F.MO[idx + lane] = (bf16)(pk2(a0 * r * gain[h * 128 + lane] * bf2f(OG[idx + lane]), 0.f) & 0xffffu);
              F.MO[idx + 64 + lane] = (bf16)(pk2(a1 * r * gain[h * 128 + 64 + lane] * bf2f(OG[idx + 64 + lane]), 0.f) & 0xffffu); }
            __syncthreads();
        }
    }
}

__device__ __forceinline__ void attn_naive_phase(Frame& F, int j) {
    const int tid = opaque_tid(), lane = tid & 63; (void)tid;
    LAS float* qsl = (LAS float*)(F.lds + RING_OFF + F.wave * 1024);
    const bf16* Q = (const bf16*)(F.big); const bf16* Kb = (const bf16*)(F.big + BIG_T); const bf16* V = (const bf16*)(F.big + 2 * BIG_T);
    const float lam = F.tab[T_LAM + j], oml = F.tab[T_LAM + 2 + j];
    const int gw = blockIdx.x * NWAVES + F.wave, NGW = F.G * NWAVES;
    for (int row = gw; row < BATCH * DA_HEADS * SEQ; row += NGW) {
        const int q = row & (SEQ - 1), bh = row >> 11, h = bh & 7, b = bh >> 3;
        const size_t qoff = (size_t)(b * SEQ + q) * DM + h * 256;
        { const unsigned w = *(const unsigned*)(Q + qoff + 2 * lane); const unsigned w2 = *(const unsigned*)(Q + qoff + 128 + 2 * lane);
          qsl[2 * lane] = bflo(w); qsl[2 * lane + 1] = bfhi(w); qsl[128 + 2 * lane] = bflo(w2); qsl[128 + 2 * lane + 1] = bfhi(w2); }
        LDS_WAIT(); asm volatile("" ::: "memory");
        float m1 = -1e30f, m2 = -1e30f, l1 = 0.f, l2 = 0.f; f32x4 o1 = {0.f, 0.f, 0.f, 0.f}, o2 = {0.f, 0.f, 0.f, 0.f};
        const float* bt = F.tab + T_BIAS + h * 128;
        for (int k0 = 0; k0 <= q; k0 += 64) {
            const int key = k0 + lane; const bool valid = key <= q; const int keyc = valid ? key : q;
            const v4u* kr = (const v4u*)(Kb + (size_t)(b * SEQ + keyc) * DM + h * 256);
            float s1 = 0.f, s2 = 0.f;
#pragma unroll 4
            for (int c = 0; c < 16; ++c) { const v4u a = kr[c], bb = kr[16 + c]; const LAS f32x4* q1 = (const LAS f32x4*)(qsl + 8 * c); const LAS f32x4* q2 = (const LAS f32x4*)(qsl + 128 + 8 * c);
                const f32x4 qa = q1[0], qb = q1[1], qc = q2[0], qd = q2[1];
                s1 += qa.x * bflo(a.x) + qa.y * bfhi(a.x) + qa.z * bflo(a.y) + qa.w * bfhi(a.y) + qb.x * bflo(a.z) + qb.y * bfhi(a.z) + qb.z * bflo(a.w) + qb.w * bfhi(a.w);
                s2 += qc.x * bflo(bb.x) + qc.y * bfhi(bb.x) + qc.z * bflo(bb.y) + qc.w * bfhi(bb.y) + qd.x * bflo(bb.z) + qd.y * bfhi(bb.z) + qd.z * bflo(bb.w) + qd.w * bfhi(bb.w); }
            const int dist = q - keyc; const float bias = bt[dist < 127 ? dist : 127] * LOG2E;
            const float NEG = -__builtin_inff();
            s1 = valid ? s1 + bias : NEG; s2 = valid ? s2 + bias : NEG;
            const float mn1 = fmaxf(m1, wave_max(s1)), mn2 = fmaxf(m2, wave_max(s2));
            const float a1 = __builtin_amdgcn_exp2f(m1 - mn1), a2 = __builtin_amdgcn_exp2f(m2 - mn2);
            const float p1 = __builtin_amdgcn_exp2f(s1 - mn1), p2 = __builtin_amdgcn_exp2f(s2 - mn2);
            l1 = l1 * a1 + wave_sum(p1); l2 = l2 * a2 + wave_sum(p2); o1 = o1 * a1; o2 = o2 * a2; m1 = mn1; m2 = mn2;
            const int nk = (q - k0 + 1) < 64 ? (q - k0 + 1) : 64;
            const bf16* vb = V + (size_t)(b * SEQ + k0) * DM + h * 256 + 4 * lane;
            for (int jj = 0; jj < nk; ++jj) {
                const float pj1 = __uint_as_float(__builtin_amdgcn_readlane(__float_as_uint(p1), jj)), pj2 = __uint_as_float(__builtin_amdgcn_readlane(__float_as_uint(p2), jj));
                const v2u vv = *(const v2u*)(vb + (size_t)jj * DM);
                const f32x4 vf = {bflo(vv.x), bfhi(vv.x), bflo(vv.y), bfhi(vv.y)};
                o1 = o1 + vf * pj1; o2 = o2 + vf * pj2;
            }
        }
        const float i1 = 1.0f / l1, i2 = lam / l2;
        const f32x4 o = o1 * i1 - o2 * i2;
        const float r = rsqrtf(wave_sum((o.x * o.x + o.y * o.y) + (o.z * o.z + o.w * o.w)) * (1.0f / 256.0f) + SUBLN_EPS) * oml;
        const f32x4 sg = *(const f32x4*)(F.diff_subln + j * 256 + 4 * lane);
        v2u w; w.x = pk2(o.x * r * sg.x, o.y * r * sg.y); w.y = pk2(o.z * r * sg.z, o.w * r * sg.w);
        *(v2u*)(F.MO + (size_t)(b * SEQ + q) * DM + h * 256 + 4 * lane) = w;
        asm volatile("" ::: "memory");
    }
}

struct Args { const float* in[14]; float* out; unsigned char* ws; int ph_lo, ph_hi; };
__global__ void __launch_bounds__(NWAVES * 64, 2) fwd(Args args) {
    extern __shared__ __attribute__((aligned(16))) unsigned char lds[];
    Frame F;
    F.lds = (LAS unsigned char*)lds;
    F.MISC = (volatile LAS unsigned*)(F.lds + MISC_OFF);
    F.tid = threadIdx.x; F.lane = F.tid & 63; F.wave = __builtin_amdgcn_readfirstlane(F.tid >> 6);
    F.G = gridDim.x;
    unsigned char* ws = args.ws;
    F.ctl = (gu32*)(ws + WS_CTL);
    F.x = args.in[0]; F.norm_gains = args.in[1]; F.final_norm = args.in[2]; F.ffn_w_in = args.in[3]; F.ffn_w_out = args.in[4]; F.hgrn_w_in = args.in[5]; F.hgrn_lb = args.in[6];
    F.hgrn_norm = args.in[7]; F.hgrn_w_out = args.in[8]; F.diff_w_in = args.in[9]; F.diff_lambda = args.in[10]; F.diff_subln = args.in[11]; F.diff_w_out = args.in[12]; F.rel_bias = args.in[13];
    F.out = args.out; F.tab = (float*)(ws + WS_TAB);
    F.WFI = (bf16*)(ws + WS_WFI); F.WFO = (bf16*)(ws + WS_WFO); F.WHI = (bf16*)(ws + WS_WHI); F.WHO = (bf16*)(ws + WS_WHO); F.WDI = (bf16*)(ws + WS_WDI); F.WDO = (bf16*)(ws + WS_WDO);
    F.HN = (bf16*)(ws + WS_HN); F.MO = (bf16*)(ws + WS_MO); F.big = ws + WS_BIG;
    for (int u = F.tid; u < (LDS_BYTES - LDSCTL_OFF) / 4; u += NWAVES * 64) ((LAS unsigned*)(F.lds + LDSCTL_OFF))[u] = 0u;
    __syncthreads();
    const int lo = args.ph_lo, hi = args.ph_hi;
    XcdBarrier bar; bar.bar = (unsigned*)(F.ctl + CW_BAR); bar.x = 0; bar.st = nullptr;
    if (hi - lo > 1) bar = xcd_barrier_post((unsigned*)(F.ctl + CW_BAR), F.MISC + 8);
#define IN(k) (lo <= (k) && (k) < hi)
#define SEAM(k) do { if (lo <= (k) && (k) + 1 < hi) xcd_barrier(bar); } while (0)

    if (IN(0)) p0_prologue(F);
    SEAM(0);
    for (int i = 0; i < DEPTH; ++i) {
        const int pb = 1 + 10 * i, j = i >> 1; const bool is_attn = (i & 1) != 0;
        for (int f = 0; f < 3; ++f) {
            const int pn = pb + (f == 0 ? 0 : (f == 1 ? 3 : 7));
            const float* hsrc = (i == 0 && f == 0) ? F.x : F.out;
            if (IN(pn)) rmsnorm_phase(F, hsrc, F.norm_gains + (size_t)(i * 3 + f) * DM, F.HN);
            SEAM(pn);
            int po, K_out; float scale; const bf16* A_out; const bf16* W_out;
            if (f != 1) {
                const int w = i * 2 + (f >> 1);
                if (IN(pn + 1)) {
                    pg8::Gemm g{F.HN, F.WFI + (size_t)w * NFF2 * DM, M, NFF2, DM}; pg8::StaticOrder S; S.init(M, NFF2, F.G, (int)blockIdx.x);
                    pg8::EpiSwiglu E{(bf16*)F.big, DFF};
                    pg8::gemm_phase<pg8::EpiSwiglu, pg8::StaticOrder, PG8_ALIGN, PG8_SP2>(F.lds + RING_OFF, g, S, E);
                }
                SEAM(pn + 1);
                po = pn + 2; K_out = DFF; scale = 0.5f; A_out = (const bf16*)F.big; W_out = F.WFO + (size_t)w * DM * DFF;
            } else {
                if (!is_attn) {
                    if (IN(pn + 1)) {
                        pg8::Gemm g{F.HN, F.WHI + (size_t)j * HG_PROJ * DM, M, HG_PROJ, DM}; pg8::StaticOrder S; S.init(M, HG_PROJ, F.G, (int)blockIdx.x);
                        pg8::EpiHgrn E{F.big, BIG_T, F.tab + T_LOWA + j * DM, F.tab + T_LOW1 + j * DM, F.tab + T_LOWM + j * DM};
                        pg8::gemm_phase<pg8::EpiHgrn, pg8::StaticOrder, PG8_ALIGN, PG8_SP2>(F.lds + RING_OFF, g, S, E);
                    }
                    SEAM(pn + 1);
                    if (IN(pn + 2)) scan_naive_phase(F, j);
                    SEAM(pn + 2);
                } else {
                    if (IN(pn + 1)) {
                        pg8::Gemm g{F.HN, F.WDI + (size_t)j * DA_PROJ * DM, M, DA_PROJ, DM}; pg8::StaticOrder S; S.init(M, DA_PROJ, F.G, (int)blockIdx.x);
                        pg8::EpiBf16<0> E{(bf16*)F.big, DM, nullptr, DM, (size_t)M * DM, QSCALE};
                        pg8::gemm_phase<pg8::EpiBf16<0>, pg8::StaticOrder, PG8_ALIGN, PG8_SP2>(F.lds + RING_OFF, g, S, E);
                    }
                    SEAM(pn + 1);
                    if (IN(pn + 2)) attn_naive_phase(F, j);
                    SEAM(pn + 2);
                }
                po = pn + 3; K_out = DM; scale = 1.0f; A_out = F.MO; W_out = is_attn ? F.WDO + (size_t)j * DM * DM : F.WHO + (size_t)j * DM * DM;
            }
            if (IN(po)) {
                pg8::Gemm g{A_out, W_out, M, DM, K_out}; pg8::StaticOrder S; S.init(M, DM, F.G, (int)blockIdx.x);
                pg8::EpiRes E{hsrc, F.out, DM, scale};
                pg8::gemm_phase<pg8::EpiRes, pg8::StaticOrder, PG8_ALIGN, PG8_SP2>(F.lds + RING_OFF, g, S, E);
            }
            SEAM(po);
        }
    }
    if (IN(NPHASE - 1)) final_norm_phase(F);
#undef IN
#undef SEAM
}

extern "C" void kernel_launch(void* const* d_in, const int* in_sizes, int n_in, void* d_out, int out_size, void* d_ws, size_t ws_size, hipStream_t stream) {
    static int grid = 0;
    if (grid == 0) {
        if (n_in != 14 || in_sizes[0] != M * DM || out_size != M * DM || ws_size < WS_END) {
            fprintf(stderr, "kernel_launch: built for 14 inputs, x/out of %d floats, >= %zu bytes of workspace; got n_in %d, in0 %d, out %d, ws %zu; nothing launched\n", M * DM, (size_t)WS_END, n_in, n_in > 0 ? in_sizes[0] : -1, out_size, ws_size);
            grid = -1; return; }
        int dev = 0, cus = 0, per_cu = 0;
        if (hipGetDevice(&dev) != hipSuccess || hipDeviceGetAttribute(&cus, hipDeviceAttributeMultiprocessorCount, dev) != hipSuccess) { fprintf(stderr, "kernel_launch: device query failed\n"); grid = -1; return; }
        if (hipFuncSetAttribute((const void*)fwd, hipFuncAttributeMaxDynamicSharedMemorySize, LDS_BYTES) != hipSuccess) { fprintf(stderr, "kernel_launch: hipFuncSetAttribute failed\n"); grid = -1; return; }
        if (hipOccupancyMaxActiveBlocksPerMultiprocessor(&per_cu, (const void*)fwd, NWAVES * 64, LDS_BYTES) != hipSuccess || per_cu < 1)
            fprintf(stderr, "kernel_launch: note: occupancy query reports %d workgroups per CU\n", per_cu);
        (void)hipGetLastError();
        grid = cus;
    }
    if (grid < 0) return;
    if (hipMemsetAsync((char*)d_ws + WS_CTL, 0, CTL_ZERO_BYTES, stream) != hipSuccess) { fprintf(stderr, "kernel_launch: memset failed\n"); return; }
    Args a{};
    for (int i = 0; i < 14; ++i) a.in[i] = (const float*)d_in[i];
    a.out = (float*)d_out; a.ws = (unsigned char*)d_ws;
#if MK_ONE_LAUNCH
    a.ph_lo = 0; a.ph_hi = NPHASE;
    hipLaunchKernelGGL(fwd, dim3(grid), dim3(NWAVES * 64), LDS_BYTES, stream, a);
#else
    for (int p = 0; p < NPHASE; ++p) { a.ph_lo = p; a.ph_hi = p + 1; hipLaunchKernelGGL(fwd, dim3(grid), dim3(NWAVES * 64), LDS_BYTES, stream, a); }
#endif
    const hipError_t le = hipPeekAtLastError();
    if (le != hipSuccess) fprintf(stderr, "kernel_launch: launch failed: %s\n", hipGetErrorName(le));
}
```
